# Optimizing an MI355X kernel written in HIP

```python
import jax, jax.numpy as jnp
from jax import lax
import numpy as np

D_MODEL = 1024
BATCH = 8
SEQ = 4096
DEPTH = 1

CHUNK = 64
Q_BLOCK = 128
EPS = 1e-6
HEAD_DIM = 64
A_HEADS = 6
A_WIDTH = A_HEADS * HEAD_DIM
IDX_HEADS = 8
IDX_DIM = 64
TOPK_MAX = 256
ALIBI_MAX = 8.0
B_HEADS = 6
B_NOPE = 64
B_ROPE = 32
B_V = 64
B_WIDTH = B_HEADS * B_V
Q_LORA = 256
KV_LORA = 128
ROPE_THETA = 10000.0
M_HEADS = 4
M_WIDTH = M_HEADS * HEAD_DIM
N_MEM = 256
D_MIX = A_WIDTH + B_WIDTH + M_WIDTH
IN_SPLITS = (A_WIDTH, A_WIDTH, A_WIDTH, IDX_HEADS * IDX_DIM, IDX_DIM, IDX_HEADS, A_WIDTH,
             Q_LORA, KV_LORA, B_ROPE, B_WIDTH,
             M_WIDTH, M_WIDTH)
D_IN = sum(IN_SPLITS)

kernel_name = "hybrid_dsa_mla_memory_gated_layer"


def rms_norm(x, g):
    xf = x.astype(jnp.float32)
    y = xf * lax.rsqrt(jnp.mean(xf * xf, axis=-1, keepdims=True) + EPS)
    return (y * g.astype(jnp.float32)).astype(x.dtype)


def rope(x, pos):
    half = x.shape[-1] // 2
    inv = 1.0 / (ROPE_THETA ** (jnp.arange(half, dtype=jnp.float32) / half))
    ang = pos.astype(jnp.float32)[:, None] * inv[None, :]
    cos = jnp.cos(ang)[None, :, None, :]
    sin = jnp.sin(ang)[None, :, None, :]
    xf = x.astype(jnp.float32)
    x1, x2 = xf[..., :half], xf[..., half:]
    return jnp.concatenate([x1 * cos - x2 * sin, x1 * sin + x2 * cos], axis=-1).astype(x.dtype)


def alibi_slopes(n):
    return 2.0 ** (-ALIBI_MAX * jnp.arange(1, n + 1, dtype=jnp.float32) / n)


def sweep_query_blocks(fn, seq):
    out = lax.map(fn, jnp.arange(seq // Q_BLOCK))
    nb, b, qb, h, d = out.shape
    return jnp.transpose(out, (1, 0, 2, 3, 4)).reshape(b, nb * qb, h, d)


def dsa_attention(q, k, v, q_idx, k_idx, w_idx, g_q, g_k, pos, topk):
    B, S, _ = q.shape
    q = rms_norm(q.reshape(B, S, A_HEADS, HEAD_DIM), g_q)
    k = rms_norm(k.reshape(B, S, A_HEADS, HEAD_DIM), g_k)
    v = v.reshape(B, S, A_HEADS, HEAD_DIM)
    q_idx = q_idx.reshape(B, S, IDX_HEADS, IDX_DIM)
    slopes = alibi_slopes(A_HEADS)
    chunk = pos // CHUNK
    scale = HEAD_DIM ** -0.5

    def block(i):
        start = i * Q_BLOCK
        qpos = lax.dynamic_slice_in_dim(pos, start, Q_BLOCK)
        qchunk = qpos // CHUNK
        qi_blk = lax.dynamic_slice_in_dim(q_idx, start, Q_BLOCK, axis=1)
        w_blk = lax.dynamic_slice_in_dim(w_idx, start, Q_BLOCK, axis=1)
        q_blk = lax.dynamic_slice_in_dim(q, start, Q_BLOCK, axis=1)
        rel = jnp.einsum('bqhd,bkd->bqhk', qi_blk, k_idx).astype(jnp.float32)
        score = jnp.einsum('bqh,bqhk->bqk', w_blk.astype(jnp.float32), jax.nn.relu(rel))
        admissible = chunk[None, :] <= qchunk[:, None]
        score = jnp.where(admissible[None], score, -jnp.inf)
        _, idx = lax.top_k(score, topk)
        valid = (idx // CHUNK) <= qchunk[None, :, None]
        k_sel = jax.vmap(lambda kb, ib: kb[ib])(k, idx)
        v_sel = jax.vmap(lambda vb, ib: vb[ib])(v, idx)
        s = jnp.einsum('bqhd,bqkhd->bhqk', q_blk, k_sel).astype(jnp.float32) * scale
        dist = jnp.abs(qpos[None, :, None] - idx).astype(jnp.float32)
        s = s - slopes[None, :, None, None] * dist[:, None]
        s = jnp.where(valid[:, None], s, -jnp.inf)
        p = jax.nn.softmax(s, axis=-1).astype(v.dtype)
        return jnp.einsum('bhqk,bqkhd->bqhd', p, v_sel)

    return sweep_query_blocks(block, S)


def mla_attention(c_q, c_kv, k_rope, w_uq, g_cq, w_ukv, g_ckv, g_q, g_k, pos):
    B, S, _ = c_q.shape
    q = (rms_norm(c_q, g_cq) @ w_uq).reshape(B, S, B_HEADS, B_NOPE + B_ROPE)
    kv = (rms_norm(c_kv, g_ckv) @ w_ukv).reshape(B, S, B_HEADS, B_NOPE + B_V)
    k_nope, v = kv[..., :B_NOPE], kv[..., B_NOPE:]
    k = jnp.concatenate(
        [k_nope, jnp.broadcast_to(k_rope[:, :, None, :], (B, S, B_HEADS, B_ROPE))], axis=-1)
    q = rms_norm(q, g_q)
    k = rms_norm(k, g_k)
    q = jnp.concatenate([q[..., :B_NOPE], rope(q[..., B_NOPE:], pos)], axis=-1)
    k = jnp.concatenate([k[..., :B_NOPE], rope(k[..., B_NOPE:], pos)], axis=-1)
    scale = (B_NOPE + B_ROPE) ** -0.5
    chunk = pos // CHUNK

    def block(i):
        start = i * Q_BLOCK
        q_blk = lax.dynamic_slice_in_dim(q, start, Q_BLOCK, axis=1)
        qchunk = lax.dynamic_slice_in_dim(chunk, start, Q_BLOCK)
        s = jnp.einsum('bqhd,bkhd->bhqk', q_blk, k).astype(jnp.float32) * scale
        s = jnp.where(chunk[None, :] <= qchunk[:, None], s, -jnp.inf)
        p = jax.nn.softmax(s, axis=-1).astype(v.dtype)
        return jnp.einsum('bhqk,bkhd->bqhd', p, v)

    return sweep_query_blocks(block, S)


def memory_attention(q, mem, g_mem, w_mk, w_mv, g_q, g_k):
    B, S, _ = q.shape
    N = mem.shape[1]
    q = rms_norm(q.reshape(B, S, M_HEADS, HEAD_DIM), g_q)
    m = rms_norm(mem, g_mem)
    k = rms_norm((m @ w_mk).reshape(B, N, M_HEADS, HEAD_DIM), g_k)
    v = (m @ w_mv).reshape(B, N, M_HEADS, HEAD_DIM)
    s = jnp.einsum('bqhd,bkhd->bhqk', q, k).astype(jnp.float32) * (HEAD_DIM ** -0.5)
    p = jax.nn.softmax(s, axis=-1).astype(v.dtype)
    return jnp.einsum('bhqk,bkhd->bqhd', p, v)


def setup_inputs(seed: int = 0) -> dict:
    key = jax.random.key(seed)
    ks = jax.random.split(key, 20)
    f32 = jnp.float32

    def w(k, shape, fan_in):
        return jax.random.normal(k, shape, f32) * (fan_in ** -0.5)

    def gain(k, shape):
        return 1.0 + 0.1 * jax.random.normal(k, shape, f32)

    return {
        "x": jax.random.normal(ks[0], (BATCH, SEQ, D_MODEL), f32),
        "mem": jax.random.normal(ks[1], (BATCH, N_MEM, D_MODEL), f32),
        "g_in": gain(ks[2], (DEPTH, D_MODEL)),
        "w_in": w(ks[3], (DEPTH, D_MODEL, D_IN), D_MODEL),
        "w_uq": w(ks[4], (DEPTH, Q_LORA, B_HEADS * (B_NOPE + B_ROPE)), Q_LORA),
        "g_cq": gain(ks[5], (DEPTH, Q_LORA)),
        "w_ukv": w(ks[6], (DEPTH, KV_LORA, B_HEADS * (B_NOPE + B_V)), KV_LORA),
        "g_ckv": gain(ks[7], (DEPTH, KV_LORA)),
        "g_qa": gain(ks[8], (DEPTH, HEAD_DIM)),
        "g_ka": gain(ks[9], (DEPTH, HEAD_DIM)),
        "g_qb": gain(ks[10], (DEPTH, B_NOPE + B_ROPE)),
        "g_kb": gain(ks[11], (DEPTH, B_NOPE + B_ROPE)),
        "g_mem": gain(ks[12], (DEPTH, D_MODEL)),
        "w_mk": w(ks[13], (DEPTH, D_MODEL, M_WIDTH), D_MODEL),
        "w_mv": w(ks[14], (DEPTH, D_MODEL, M_WIDTH), D_MODEL),
        "g_qm": gain(ks[15], (DEPTH, HEAD_DIM)),
        "g_km": gain(ks[16], (DEPTH, HEAD_DIM)),
        "w_out": w(ks[17], (DEPTH, D_MIX, D_MODEL), D_MIX),
    }


def reference(x, mem, g_in, w_in, w_uq, g_cq, w_ukv, g_ckv, g_qa, g_ka, g_qb, g_kb,
              g_mem, w_mk, w_mv, g_qm, g_km, w_out):
    B, S, _ = x.shape
    pos = jnp.arange(S, dtype=jnp.int32)
    topk = min(TOPK_MAX, S // 4)
    offsets = [int(o) for o in np.cumsum(IN_SPLITS)[:-1]]
    for l in range(DEPTH):
        h = rms_norm(x, g_in[l])
        u = h @ w_in[l]
        (q_a, k_a, v_a, q_idx, k_idx, w_idx, z_a,
         c_q, c_kv, k_rope, z_b, q_m, z_m) = jnp.split(u, offsets, axis=-1)
        y_a = dsa_attention(q_a, k_a, v_a, q_idx, k_idx, w_idx, g_qa[l], g_ka[l], pos, topk)
        y_b = mla_attention(c_q, c_kv, k_rope, w_uq[l], g_cq[l], w_ukv[l], g_ckv[l],
                            g_qb[l], g_kb[l], pos)
        y_m = memory_attention(q_m, mem, g_mem[l], w_mk[l], w_mv[l], g_qm[l], g_km[l])
        y = jnp.concatenate([
            y_a.reshape(B, S, A_WIDTH) * jax.nn.silu(z_a),
            y_b.reshape(B, S, B_WIDTH) * jax.nn.silu(z_b),
            y_m.reshape(B, S, M_WIDTH) * jax.nn.silu(z_m),
        ], axis=-1)
        x = x + y @ w_out[l]
    return x
```

```cpp
#include <hip/hip_runtime.h>
#include <cstdio>
#include <cstdint>

#ifndef MK_N_LAUNCHES
#define MK_N_LAUNCHES 1
#endif
#ifndef EN_B
#define EN_B 1
#endif
#ifndef EN_A
#define EN_A 1
#endif

#define LAS __attribute__((address_space(3)))
#define GAS __attribute__((address_space(1)))
typedef unsigned short bf16_t;
typedef short bf16x8 __attribute__((ext_vector_type(8)));
typedef short s16x4 __attribute__((ext_vector_type(4)));
typedef float f32x2 __attribute__((ext_vector_type(2)));
typedef float f32x4 __attribute__((ext_vector_type(4)));
typedef float f32x16 __attribute__((ext_vector_type(16)));
typedef unsigned u32x2 __attribute__((ext_vector_type(2)));
typedef unsigned u32x4 __attribute__((ext_vector_type(4)));

constexpr int NB = 8, SEQ = 4096, DMODEL = 1024, MTOK = NB * SEQ;
constexpr int NIN = 3432, NINP = 3584;
constexpr int NMEM = 256, MMEM = NB * NMEM;
constexpr float EPS = 1e-6f, LOG2E = 1.4426950408889634f;
constexpr float C2_64 = 0.125f * LOG2E;
constexpr float C2_96 = 0.10206207261596575f * LOG2E;

constexpr size_t MiB = 1u << 20;
constexpr size_t WS_CTL = 0, CTL_ZERO_BYTES = 1 * MiB;
constexpr size_t WS_ROPE = 1 * MiB;
constexpr size_t WS_WIN = 2 * MiB;
constexpr size_t WS_WOUT = 9 * MiB;
constexpr size_t WS_WUQ = 11 * MiB;
constexpr size_t WS_WUKV = 11 * MiB + 512 * 1024;
constexpr size_t WS_WM = 12 * MiB;
constexpr size_t WS_MN = 13 * MiB;
constexpr size_t WS_KM = 17 * MiB, WS_VM = 18 * MiB;
constexpr size_t WS_WI = 19 * MiB;
constexpr size_t WS_CQSS = 20 * MiB, WS_CKVSS = 20 * MiB + 512 * 1024;
constexpr size_t WS_KR = 21 * MiB;
constexpr size_t WS_KI = 23 * MiB;
constexpr size_t WS_MASK = 27 * MiB;
constexpr size_t WS_CKV = 43 * MiB;
constexpr size_t WS_CQ = 51 * MiB;
constexpr size_t WS_XN = 67 * MiB;
constexpr size_t WS_Y = WS_XN;
constexpr size_t WS_QA = 131 * MiB, WS_KA = 155 * MiB, WS_VA = 179 * MiB;
constexpr size_t WS_QI = 203 * MiB;
constexpr size_t WS_Z = 235 * MiB;
constexpr size_t WS_QM = 299 * MiB;
constexpr size_t WS_QB = 315 * MiB, WS_KB = 351 * MiB;
constexpr size_t WS_VB = 387 * MiB;
constexpr size_t WS_END = 411 * MiB;
constexpr int CW_Q_IDX = 64, CW_Q_P2 = 128, CW_Q_ATT = 192;
constexpr int CW_BAR = 4096;

constexpr int LDS_SCRATCH = 143360;
constexpr int MISC_OFF = LDS_SCRATCH;
constexpr int LDS_BYTES = 147456;

__device__ __forceinline__ unsigned cvt_pk_bf16(float lo, float hi) { unsigned r; asm volatile("v_cvt_pk_bf16_f32 %0, %1, %2" : "=v"(r) : "v"(lo), "v"(hi)); return r; }
__device__ __forceinline__ float fast_rcp(float x) { return __builtin_amdgcn_rcpf(x); }
__device__ __forceinline__ float fast_exp2(float x) { return __builtin_amdgcn_exp2f(x); }
__device__ __forceinline__ float silu_f(float v) { return v * fast_rcp(1.0f + fast_exp2(-v * LOG2E)); }
__device__ __forceinline__ int crow(int r, int hi) { return (r & 3) + 8 * (r >> 2) + 4 * hi; }
namespace pg8 {
#define PG8_LAS __attribute__((address_space(3)))
typedef unsigned short bf16_t;
typedef short bf16x8 __attribute__((ext_vector_type(8)));
typedef float f32x4 __attribute__((ext_vector_type(4)));
typedef unsigned u32x4 __attribute__((ext_vector_type(4)));
constexpr int BM = 256, BK = 64, HALF = 128, HTB = HALF * BK * 2  , STAGE_BYTES = 8 * HTB, NXCD = 8, WGM = 8;

__host__ __device__ __forceinline__ int lds_byte(int r, int c) { const int st = (r >> 4) * 2 + (c >> 5), rr = r & 15, cc = c & 31, ob = rr * 64 + cc * 2; return st * 1024 + (ob ^ (((ob >> 9) & 1) << 5)); }
__host__ __device__ __forceinline__ void stage_rc(int b, int& R, int& C) { const int st = b / 1024, sb = b % 1024, swz = sb ^ (((sb >> 9) & 1) << 5); R = (st >> 1) * 16 + swz / 64; C = (st & 1) * 32 + (swz % 64) / 2; }
__host__ __device__ __forceinline__ int perm32(int rho) { const int n = rho >> 4, i = rho & 15; return 8 * (i >> 2) + 4 * n + (i & 3); }

struct Unit { int pm, pn; };
struct Gemm { const bf16_t* A; const bf16_t* Bt; int M, N, K; };

struct StaticOrder {
    int nM, nN, nwg, G, c;
    __host__ __device__ void init(int M, int N, int G_, int c_) { nM = M / BM; nN = N / BM; nwg = nM * nN; G = G_; c = c_; }
    __host__ __device__ bool next(int i, Unit& u) const {
        const long L = (long)i * G + c; if (L >= nwg) return false;
        int wgid = (int)L; { const int q = nwg / NXCD, r = nwg % NXCD, xcd = wgid % NXCD, off = wgid / NXCD; wgid = (xcd < r ? xcd * (q + 1) : r * (q + 1) + (xcd - r) * q) + off; }
        const int nig = WGM * nN, gid = wgid / nig, fm = gid * WGM, gsz = (nM - fm) < WGM ? (nM - fm) : WGM;
        u.pm = fm + ((wgid % nig) % gsz); u.pn = (wgid % nig) / gsz; return true;
    }
    __device__ __forceinline__ void a_ready(const Unit&) const {}
    __device__ __forceinline__ void done(const Unit&) const {}
};

template <int MODE>
__device__ __forceinline__ void slot_store(const f32x4 (&acc)[2][2][4][2], int row0, int fq, bf16_t* dst, long bstride, int tstride, int rshift,
                                           const float* gain, float gscale, float* ssout, int ssn, int ssi) {
    f32x4 gv[2][2];
    if (MODE == 2) {
#pragma unroll
        for (int bj = 0; bj < 2; ++bj)
#pragma unroll
            for (int n = 0; n < 2; ++n) gv[bj][n] = *(const f32x4*)(gain + 32 * bj + 8 * fq + 4 * n) * gscale;
    }
    const int rmask = (1 << rshift) - 1;
#pragma unroll
    for (int ai = 0; ai < 2; ++ai)
#pragma unroll
        for (int m = 0; m < 4; ++m) {
            const int row = row0 + ai * 128 + m * 16;
            f32x4 v[2][2];
#pragma unroll
            for (int bj = 0; bj < 2; ++bj)
#pragma unroll
                for (int n = 0; n < 2; ++n) v[bj][n] = acc[ai][bj][m][n];
            if (MODE == 2 || MODE == 5) {
                float ss = 0.f;
#pragma unroll
                for (int bj = 0; bj < 2; ++bj)
#pragma unroll
                    for (int n = 0; n < 2; ++n) { const f32x4 x = v[bj][n]; ss += (x[0] * x[0] + x[1] * x[1]) + (x[2] * x[2] + x[3] * x[3]); }
                ss += __shfl_xor(ss, 16); ss += __shfl_xor(ss, 32);
                if (MODE == 2) { const float rs = rsqrtf(ss * (1.0f / 64.0f) + EPS);
#pragma unroll
                    for (int bj = 0; bj < 2; ++bj)
#pragma unroll
                        for (int n = 0; n < 2; ++n) v[bj][n] = v[bj][n] * rs * gv[bj][n]; }
                if (MODE == 5) { if (fq == 0) ssout[(size_t)row * ssn + ssi] = ss; }
            }
            if (MODE == 3) {
#pragma unroll
                for (int bj = 0; bj < 2; ++bj)
#pragma unroll
                    for (int n = 0; n < 2; ++n)
#pragma unroll
                        for (int i = 0; i < 4; ++i) v[bj][n][i] = silu_f(v[bj][n][i]);
            }
            bf16_t* p = dst + (size_t)(row >> rshift) * bstride + (size_t)(row & rmask) * tstride + 8 * fq;
#pragma unroll
            for (int bj = 0; bj < 2; ++bj) { u32x4 w; w.x = cvt_pk_bf16(v[bj][0][0], v[bj][0][1]); w.y = cvt_pk_bf16(v[bj][0][2], v[bj][0][3]); w.z = cvt_pk_bf16(v[bj][1][0], v[bj][1][1]); w.w = cvt_pk_bf16(v[bj][1][2], v[bj][1][3]);
                *(u32x4*)(p + 32 * bj) = w; }
        }
}

template <int WHICH> struct EpiSlots {
    static constexpr bool PERM = true, AFTER_DRAIN = false;
    unsigned char* ws; const float* g_qa; const float* g_ka; const float* g_qm; const float* g_km;
    __device__ __forceinline__ void operator()(const f32x4 (&acc)[2][2][4][2], const Unit& u, int wr, int wc, int fr, int fq) const {
        const int slot = __builtin_amdgcn_readfirstlane(u.pn * 4 + wc);
        const int row0 = u.pm * BM + wr * 64 + fr;
        int mode = 0; bf16_t* dst = nullptr; long bstride = 0; int tstride = 0; const float* gain = nullptr; float gscale = 1.f; float* ssout = nullptr; int ssn = 0, ssi = 0;
        if (WHICH == 1) {
            if (slot < 4) { mode = 2; dst = (bf16_t*)(ws + WS_KM) + (size_t)slot * NMEM * 64; gain = g_km; }
            else { mode = 1; dst = (bf16_t*)(ws + WS_VM) + (size_t)(slot - 4) * NMEM * 64; }
            bstride = 4 * NMEM * 64; tstride = 64;
            if (mode == 2) slot_store<2>(acc, row0, fq, dst, bstride, tstride, 8, gain, gscale, nullptr, 0, 0);
            else slot_store<1>(acc, row0, fq, dst, bstride, tstride, 8, nullptr, 1.f, nullptr, 0, 0);
            return;
        }
        if (slot < 6) { mode = 2; dst = (bf16_t*)(ws + WS_QA) + (size_t)slot * SEQ * 64; bstride = 6L * SEQ * 64; tstride = 64; gain = g_qa; gscale = C2_64; }
        else if (slot < 12) { mode = 2; dst = (bf16_t*)(ws + WS_KA) + (size_t)(slot - 6) * SEQ * 64; bstride = 6L * SEQ * 64; tstride = 64; gain = g_ka; }
        else if (slot < 18) { mode = 1; dst = (bf16_t*)(ws + WS_VA) + (size_t)(slot - 12) * SEQ * 64; bstride = 6L * SEQ * 64; tstride = 64; }
        else if (slot < 26) { mode = 1; dst = (bf16_t*)(ws + WS_QI) + (slot - 18) * 64; bstride = (long)SEQ * 512; tstride = 512; }
        else if (slot == 26) { mode = 1; dst = (bf16_t*)(ws + WS_KI); bstride = (long)SEQ * 64; tstride = 64; }
        else if (slot == 27) { mode = 4; }
        else if (slot < 34) { mode = 3; dst = (bf16_t*)(ws + WS_Z) + (slot - 28) * 64; bstride = (long)SEQ * 1024; tstride = 1024; }
        else if (slot < 38) { mode = 5; dst = (bf16_t*)(ws + WS_CQ) + (slot - 34) * 64; bstride = (long)SEQ * 256; tstride = 256; ssout = (float*)(ws + WS_CQSS); ssn = 4; ssi = slot - 34; }
        else if (slot < 40) { mode = 5; dst = (bf16_t*)(ws + WS_CKV) + (slot - 38) * 64; bstride = (long)SEQ * 128; tstride = 128; ssout = (float*)(ws + WS_CKVSS); ssn = 2; ssi = slot - 38; }
        else if (slot < 46) { mode = 3; dst = (bf16_t*)(ws + WS_Z) + 384 + (slot - 40) * 64; bstride = (long)SEQ * 1024; tstride = 1024; }
        else if (slot < 50) { mode = 2; dst = (bf16_t*)(ws + WS_QM) + (size_t)(slot - 46) * SEQ * 64; bstride = 4L * SEQ * 64; tstride = 64; gain = g_qm; gscale = C2_64; }
        else if (slot < 54) { mode = 3; dst = (bf16_t*)(ws + WS_Z) + 768 + (slot - 50) * 64; bstride = (long)SEQ * 1024; tstride = 1024; }
        if (mode == 1) slot_store<1>(acc, row0, fq, dst, bstride, tstride, 12, nullptr, 1.f, nullptr, 0, 0);
        else if (mode == 2) slot_store<2>(acc, row0, fq, dst, bstride, tstride, 12, gain, gscale, nullptr, 0, 0);
        else if (mode == 3) slot_store<3>(acc, row0, fq, dst, bstride, tstride, 12, nullptr, 1.f, nullptr, 0, 0);
        else if (mode == 5) slot_store<5>(acc, row0, fq, dst, bstride, tstride, 12, nullptr, 1.f, ssout, ssn, ssi);
        else if (mode == 4) {
            float* Wi = (float*)(ws + WS_WI); bf16_t* Kr = (bf16_t*)(ws + WS_KR);
#pragma unroll
            for (int ai = 0; ai < 2; ++ai)
#pragma unroll
                for (int m = 0; m < 4; ++m) { const int row = row0 + ai * 128 + m * 16;
                    if (fq == 0) { *(f32x4*)(Wi + (size_t)row * 8) = acc[ai][0][m][0]; *(f32x4*)(Wi + (size_t)row * 8 + 4) = acc[ai][0][m][1]; }
                    const f32x4 a = acc[ai][1][m][0], b = acc[ai][1][m][1]; u32x4 w; w.x = cvt_pk_bf16(a[0], a[1]); w.y = cvt_pk_bf16(a[2], a[3]); w.z = cvt_pk_bf16(b[0], b[1]); w.w = cvt_pk_bf16(b[2], b[3]);
                    *(u32x4*)(Kr + (size_t)row * 32 + 8 * fq) = w; }
        }
    }
};
struct EpiOut {
    static constexpr bool PERM = false, AFTER_DRAIN = false;
    const float* x; float* out;
    __device__ __forceinline__ void operator()(const f32x4 (&acc)[2][2][4][2], const Unit& u, int wr, int wc, int fr, int fq) const {
        const int col0 = u.pn * BM + wc * 32 + 4 * fq;
#pragma unroll
        for (int ai = 0; ai < 2; ++ai)
#pragma unroll
            for (int m = 0; m < 4; ++m) { const size_t off = (size_t)(u.pm * BM + ai * HALF + wr * 64 + m * 16 + fr) * DMODEL + col0;
#pragma unroll
                for (int bj = 0; bj < 2; ++bj)
#pragma unroll
                    for (int n = 0; n < 2; ++n) { const f32x4 bs = *(const f32x4*)(x + off + bj * HALF + n * 16); *(f32x4*)(out + off + bj * HALF + n * 16) = bs + acc[ai][bj][m][n]; } }
    }
};
template <class Epi, class Sched, bool ALIGN_EPI = false, bool SP2 = false>
__device__ __forceinline__ void gemm_phase(PG8_LAS unsigned char* lds, const Gemm g, const Sched& S, const Epi& E) {
    const int tid = threadIdx.x, wid = __builtin_amdgcn_readfirstlane(tid >> 6), lane = tid & 63, wr = wid >> 2, wc = wid & 3, fr = lane & 15, fq = lane >> 4;
    const int K = g.K, nt = K / BK;
    unsigned voffA[2], voffB[2];
#pragma unroll
    for (int i = 0; i < 2; ++i) { int R, C; stage_rc(tid * 16 + i * 8192, R, C); const int Rb = Epi::PERM ? ((R & ~31) + perm32(R & 31)) : R;
        voffA[i] = (unsigned)(R * K + C) * 2u; voffB[i] = (unsigned)(Rb * K + C) * 2u; }
    const size_t kstep = (size_t)(BK * 2);
    const size_t hstep = (size_t)HALF * K * 2;
    const size_t tstep = 2 * hstep;
    const unsigned ldsw = (unsigned)wid * 1024u;
    const int aoff = lds_byte(wr * 64 + fr, fq * 8), boff = lds_byte(wc * 32 + fr, fq * 8);
#define PG8_SA(b, h) (((b) * 2 + (h)) * HTB)
#define PG8_SB(b, h) ((4 + (b) * 2 + (h)) * HTB)
#define PG8_STAGE(bufoff, gbase, voff) do { _Pragma("unroll") for (int _i = 0; _i < 2; ++_i) \
        __builtin_amdgcn_global_load_lds((const unsigned*)((const char*)(gbase) + (voff)[_i]), (PG8_LAS unsigned*)(lds + (bufoff) + ldsw + _i * 8192), 16, 0, 0); } while (0)
#define PG8_LDA(dst, b, h) do { _Pragma("unroll") for (int m = 0; m < 4; ++m) _Pragma("unroll") for (int k = 0; k < 2; ++k) dst[m][k] = *(const PG8_LAS bf16x8*)(lds + PG8_SA(b, h) + aoff + m * 2048 + k * 1024); } while (0)
#define PG8_LDB(dst, b, h) do { _Pragma("unroll") for (int n = 0; n < 2; ++n) _Pragma("unroll") for (int k = 0; k < 2; ++k) dst[n][k] = *(const PG8_LAS bf16x8*)(lds + PG8_SB(b, h) + boff + n * 2048 + k * 1024); } while (0)
#define PG8_MMA(ai, bj, At, Bt) do { __builtin_amdgcn_s_setprio(1); _Pragma("unroll") for (int m = 0; m < 4; ++m) _Pragma("unroll") for (int n = 0; n < 2; ++n) _Pragma("unroll") for (int k = 0; k < 2; ++k) \
        acc[ai][bj][m][n] = __builtin_amdgcn_mfma_f32_16x16x32_bf16(Bt[n][k], At[m][k], acc[ai][bj][m][n], 0, 0, 0); __builtin_amdgcn_s_setprio(0); } while (0)
#define PG8_WAIT_V(n) asm volatile("s_waitcnt vmcnt(" #n ")" ::: "memory")
#define PG8_WAIT_L(n) asm volatile("s_waitcnt lgkmcnt(" #n ")" ::: "memory")
#define PG8_BAR __builtin_amdgcn_s_barrier()
#define PG8_SCHED __builtin_amdgcn_sched_barrier(0)
    Unit cur, nxt; int ui = 0;
    if (!S.next(0, cur)) return;
    f32x4 acc[2][2][4][2];
#pragma unroll
    for (int a = 0; a < 2; ++a)
#pragma unroll
        for (int b = 0; b < 2; ++b)
#pragma unroll
            for (int m = 0; m < 4; ++m)
#pragma unroll
                for (int n = 0; n < 2; ++n) acc[a][b][m][n] = (f32x4){0.f, 0.f, 0.f, 0.f};
    bf16x8 At[4][2], B0[2][2], B1[2][2];
    const char* cA = (const char*)g.A + (size_t)cur.pm * tstep; const char* cB = (const char*)g.Bt + (size_t)cur.pn * tstep;
    S.a_ready(cur);
    if constexpr (SP2) {
        PG8_STAGE(PG8_SB(0, 0), cB, voffB); PG8_STAGE(PG8_SB(0, 1), cB + hstep, voffB); PG8_STAGE(PG8_SA(0, 0), cA, voffA); PG8_STAGE(PG8_SA(0, 1), cA + hstep, voffA);
        if (wr == 1) PG8_BAR;
        PG8_WAIT_V(2); PG8_BAR;
        PG8_STAGE(PG8_SB(1, 0), cB + kstep, voffB); PG8_STAGE(PG8_SA(1, 0), cA + kstep, voffA); PG8_STAGE(PG8_SB(1, 1), cB + hstep + kstep, voffB);
        PG8_WAIT_V(6); PG8_BAR;
    } else {
        PG8_STAGE(PG8_SB(0, 0), cB, voffB); PG8_STAGE(PG8_SA(0, 0), cA, voffA); PG8_STAGE(PG8_SB(0, 1), cB + hstep, voffB); PG8_STAGE(PG8_SA(0, 1), cA + hstep, voffA);
        if (wr == 1) PG8_BAR;
        PG8_WAIT_V(4); PG8_BAR;
        PG8_STAGE(PG8_SB(1, 0), cB + kstep, voffB); PG8_STAGE(PG8_SA(1, 0), cA + kstep, voffA); PG8_STAGE(PG8_SB(1, 1), cB + hstep + kstep, voffB);
        PG8_WAIT_V(6); PG8_BAR;
    }
    for (;;) {
        const bool has_next = S.next(ui + 1, nxt);
        const char* nA = has_next ? (const char*)g.A + (size_t)nxt.pm * tstep : cA; const char* nB = has_next ? (const char*)g.Bt + (size_t)nxt.pn * tstep : cB;
        for (int t = 0; t < nt; t += 2) {
            const bool last = (t == nt - 2);
            const char* a1 = cA + (size_t)(t + 1) * kstep;
            const char* a2 = last ? nA : cA + (size_t)(t + 2) * kstep; const char* b2 = last ? nB : cB + (size_t)(t + 2) * kstep;
            const char* a3 = a2 + kstep; const char* b3 = b2 + kstep;
            if (last && has_next) S.a_ready(nxt);
            if constexpr (SP2) {
            PG8_LDB(B0, 0, 0); PG8_LDB(B1, 0, 1); PG8_SCHED; PG8_LDA(At, 0, 0); PG8_STAGE(PG8_SA(1, 1), a1 + hstep, voffA);
            PG8_WAIT_V(8); PG8_WAIT_L(0); PG8_BAR; PG8_MMA(0, 0, At, B0); PG8_MMA(0, 1, At, B1); PG8_BAR; PG8_SCHED;
            PG8_LDA(At, 0, 1); PG8_STAGE(PG8_SB(0, 0), b2, voffB); PG8_STAGE(PG8_SB(0, 1), b2 + hstep, voffB); PG8_STAGE(PG8_SA(0, 0), a2, voffA);
            PG8_WAIT_V(8); PG8_WAIT_L(0); PG8_BAR; PG8_MMA(1, 0, At, B0); PG8_MMA(1, 1, At, B1); PG8_BAR; PG8_SCHED;
            PG8_LDB(B0, 1, 0); PG8_LDB(B1, 1, 1); PG8_SCHED; PG8_LDA(At, 1, 0); PG8_STAGE(PG8_SA(0, 1), a2 + hstep, voffA);
            PG8_WAIT_V(8); PG8_WAIT_L(0); PG8_BAR; PG8_MMA(0, 0, At, B0); PG8_MMA(0, 1, At, B1); PG8_BAR; PG8_SCHED;
            PG8_LDA(At, 1, 1); PG8_STAGE(PG8_SB(1, 0), b3, voffB); PG8_STAGE(PG8_SB(1, 1), b3 + hstep, voffB); PG8_STAGE(PG8_SA(1, 0), a3, voffA);
            PG8_WAIT_V(8); PG8_WAIT_L(0); PG8_BAR; PG8_MMA(1, 0, At, B0); PG8_MMA(1, 1, At, B1); PG8_BAR; PG8_SCHED;
            } else {
            PG8_LDB(B0, 0, 0); PG8_SCHED; PG8_LDA(At, 0, 0); PG8_STAGE(PG8_SA(1, 1), a1 + hstep, voffA);
            PG8_WAIT_L(8); PG8_BAR; PG8_WAIT_L(0); PG8_MMA(0, 0, At, B0); PG8_BAR; PG8_SCHED;
            PG8_LDB(B1, 0, 1); PG8_STAGE(PG8_SB(0, 0), b2, voffB);
            PG8_BAR; PG8_WAIT_L(0); PG8_MMA(0, 1, At, B1); PG8_BAR;
            PG8_LDA(At, 0, 1); PG8_STAGE(PG8_SA(0, 0), a2, voffA);
            PG8_BAR; PG8_WAIT_L(0); PG8_MMA(1, 0, At, B0); PG8_BAR; PG8_SCHED;
            PG8_STAGE(PG8_SB(0, 1), b2 + hstep, voffB);
            PG8_WAIT_V(6); PG8_BAR; PG8_MMA(1, 1, At, B1); PG8_BAR;
            PG8_LDB(B0, 1, 0); PG8_SCHED; PG8_LDA(At, 1, 0); PG8_STAGE(PG8_SA(0, 1), a2 + hstep, voffA);
            PG8_WAIT_L(8); PG8_BAR; PG8_WAIT_L(0); PG8_MMA(0, 0, At, B0); PG8_BAR; PG8_SCHED;
            PG8_LDB(B1, 1, 1); PG8_STAGE(PG8_SB(1, 0), b3, voffB);
            PG8_BAR; PG8_WAIT_L(0); PG8_MMA(0, 1, At, B1); PG8_BAR;
            PG8_LDA(At, 1, 1); PG8_STAGE(PG8_SA(1, 0), a3, voffA);
            PG8_BAR; PG8_WAIT_L(0); PG8_MMA(1, 0, At, B0); PG8_BAR; PG8_SCHED;
            PG8_STAGE(PG8_SB(1, 1), b3 + hstep, voffB);
            PG8_WAIT_V(6); PG8_BAR; PG8_MMA(1, 1, At, B1); PG8_BAR;
            }
        }
        if constexpr (ALIGN_EPI) { if (wr == 0) PG8_BAR; }
        if constexpr (!Epi::AFTER_DRAIN) { E(acc, cur, wr, wc, fr, fq); S.done(cur); }
        if (!has_next) break;
#pragma unroll
        for (int a = 0; a < 2; ++a)
#pragma unroll
            for (int b = 0; b < 2; ++b)
#pragma unroll
                for (int m = 0; m < 4; ++m)
#pragma unroll
                    for (int n = 0; n < 2; ++n) acc[a][b][m][n] = (f32x4){0.f, 0.f, 0.f, 0.f};
        cur = nxt; cA = nA; cB = nB; ++ui;
        if constexpr (ALIGN_EPI) { if (wr == 1) PG8_BAR; }
    }
    PG8_WAIT_V(0);
    if constexpr (!ALIGN_EPI) { if (wr == 0) PG8_BAR; }
    PG8_BAR;
    if constexpr (Epi::AFTER_DRAIN) { E.fused(acc, cur, wr, wc, fr, fq, lds, wid, lane); S.done(cur); }
#undef PG8_SA
#undef PG8_SB
#undef PG8_STAGE
#undef PG8_LDA
#undef PG8_LDB
#undef PG8_MMA
#undef PG8_WAIT_V
#undef PG8_WAIT_L
#undef PG8_BAR
#undef PG8_SCHED
}
}
#define XB_TMO      128
#define XB_XCNT(j)  (256  + 64 * (j))
#define XB_XSUB(j)  (1280 + 64 * (j))
#define XB_XGEN(j)  (2304 + 64 * (j))
#define XB_TOP      3328
#define XB_TOPGEN   3392
#define XCD_BAR_WORDS 3456
#define XB_SPIN_CAP (1u << 18)

__device__ __forceinline__ unsigned xb_ld(unsigned* p)              { return __hip_atomic_load(p, __ATOMIC_RELAXED, __HIP_MEMORY_SCOPE_AGENT); }
__device__ __forceinline__ unsigned xb_add(unsigned* p, unsigned v) { return __hip_atomic_fetch_add(p, v, __ATOMIC_RELAXED, __HIP_MEMORY_SCOPE_AGENT); }
__device__ __forceinline__ unsigned xb_xcc_id() { return (unsigned)__builtin_amdgcn_s_getreg((3 << 11) | 20) & 0xFu; }
#define XB_SPIN(cond, bar) do { unsigned _sp = 0; while (cond) { __builtin_amdgcn_s_sleep(1); \
    if ((++_sp & 255u) == 0u) { if (xb_ld(&(bar)[XB_TMO])) break; if (_sp > XB_SPIN_CAP) { atomicAdd(&(bar)[XB_TMO], 1u); break; } } } } while (0)

struct XcdBarrier {
    unsigned* bar; unsigned x;
    volatile LAS unsigned* st;
};

__device__ __forceinline__ XcdBarrier xcd_barrier_post(unsigned* bar, volatile LAS unsigned* st) {
    XcdBarrier b; b.bar = bar; b.x = xb_xcc_id(); b.st = st;
    if (threadIdx.x == 0) (void)xb_add(&bar[XB_XCNT(b.x)], 1u);
    return b;
}
__device__ __forceinline__ void xcd_barrier_complete(unsigned* bar, unsigned x, unsigned& nloc, unsigned& nx) {
    const unsigned G = gridDim.x * gridDim.y * gridDim.z;
    unsigned sum, cnt, mine, sp = 0u;
    for (;;) {
        sum = 0u; cnt = 0u; mine = 0u;
#pragma unroll
        for (unsigned j = 0; j < 16; ++j) { const unsigned c = xb_ld(&bar[XB_XCNT(j)]); sum += c; cnt += (c > 0u) ? 1u : 0u; mine = (j == x) ? c : mine; }
        if (sum == G) break;
        __builtin_amdgcn_s_sleep(1);
        if ((++sp & 255u) == 0u) { if (xb_ld(&bar[XB_TMO])) break; if (sp > XB_SPIN_CAP) { atomicAdd(&bar[XB_TMO], 1u); break; } }
    }
    nloc = mine > 0u ? mine : 1u; nx = cnt > 0u ? cnt : 1u;
}

__device__ __forceinline__ void xcd_barrier(const XcdBarrier& b) {
    asm volatile("s_waitcnt vmcnt(0)" ::: "memory");
    __syncthreads();
    if (threadIdx.x == 0) {
        unsigned* bar = b.bar;
        __builtin_amdgcn_s_waitcnt(0);
        unsigned nloc = b.st[0], nx = b.st[1];
        if (nloc == 0u) { xcd_barrier_complete(bar, b.x, nloc, nx); b.st[0] = nloc; b.st[1] = nx; }
        const unsigned old = xb_add(&bar[XB_XSUB(b.x)], 1u);
        const unsigned gen = old / nloc;
        if (old + 1u == (gen + 1u) * nloc) {
            __builtin_amdgcn_fence(__ATOMIC_RELEASE, "agent");
            asm volatile("s_waitcnt vmcnt(0)" ::: "memory");
            const unsigned og = xb_add(&bar[XB_TOP], 1u);
            const unsigned tg = og / nx;
            if (og + 1u == (tg + 1u) * nx) xb_add(&bar[XB_TOPGEN], 1u);
            else XB_SPIN(xb_ld(&bar[XB_TOPGEN]) == tg, bar);
            __builtin_amdgcn_fence(__ATOMIC_ACQUIRE, "agent");
            xb_add(&bar[XB_XGEN(b.x)], 1u);
            asm volatile("s_waitcnt vmcnt(0)" ::: "memory");
        } else {
            XB_SPIN(xb_ld(&bar[XB_XGEN(b.x)]) == gen, bar);
            __builtin_amdgcn_fence(__ATOMIC_ACQUIRE, "agent");
            asm volatile("s_waitcnt vmcnt(0)" ::: "memory");
        }
    }
    __syncthreads();
}
#define LDS_WAIT() asm volatile("s_waitcnt lgkmcnt(0)" ::: "memory")
#define VM_WAIT() asm volatile("s_waitcnt vmcnt(0)" ::: "memory")
#define MFMA32(a, b, c) __builtin_amdgcn_mfma_f32_32x32x16_bf16(a, b, c, 0, 0, 0)
#define MFMA16(a, b, c) __builtin_amdgcn_mfma_f32_16x16x32_bf16(a, b, c, 0, 0, 0)
__device__ __forceinline__ unsigned f2bf(float f) { unsigned u = __builtin_bit_cast(unsigned, f); return (u + 0x7fffu + ((u >> 16) & 1u)) >> 16; }
__device__ __forceinline__ unsigned pk2(float lo, float hi) { return f2bf(lo) | (f2bf(hi) << 16); }
__device__ __forceinline__ float bf2f(unsigned short h) { return __builtin_bit_cast(float, (unsigned)h << 16); }
__device__ __forceinline__ float wave_sum(float v) {
#pragma unroll
    for (int o = 1; o < 64; o <<= 1) v += __shfl_xor(v, o);
    return v;
}
__device__ __forceinline__ int grab(unsigned* ctr, volatile LAS int* slot) {
    __syncthreads();
    if (threadIdx.x == 0) *slot = (int)atomicAdd(ctr, 1u);
    __syncthreads();
    return *slot;
}

__device__ __forceinline__ void slot_src(int slot, int bj, int& base, int& nvalid) {
    const int l0 = 32 * bj; nvalid = 32;
    if (slot < 6) base = 64 * slot + l0;
    else if (slot < 12) base = 384 + 64 * (slot - 6) + l0;
    else if (slot < 18) base = 768 + 64 * (slot - 12) + l0;
    else if (slot < 26) base = 1152 + 64 * (slot - 18) + l0;
    else if (slot == 26) base = 1664 + l0;
    else if (slot == 27) { if (bj == 0) { base = 1728; nvalid = 8; } else base = 2504; }
    else if (slot < 34) base = 1736 + 64 * (slot - 28) + l0;
    else if (slot < 38) base = 2120 + 64 * (slot - 34) + l0;
    else if (slot < 40) base = 2376 + 64 * (slot - 38) + l0;
    else if (slot < 46) base = 2536 + 64 * (slot - 40) + l0;
    else if (slot < 50) base = 2920 + 64 * (slot - 46) + l0;
    else if (slot < 54) base = 3176 + 64 * (slot - 50) + l0;
    else { base = 0; nvalid = 0; }
}
__device__ __forceinline__ void tr_item(const float* W, int K, int N, int k0, int src0, int nvalid, const float* gain, bf16_t* WT, int dst_row0, LAS float* scr, int lane) {
    const int n = lane & 31;
#pragma unroll 8
    for (int i = 0; i < 32; ++i) { const int kk = 2 * i + (lane >> 5); float v = 0.f; if (n < nvalid) v = W[(size_t)(k0 + kk) * N + src0 + n]; if (gain) v *= gain[k0 + kk]; scr[kk * 33 + n] = v; }
    LDS_WAIT(); asm volatile("" ::: "memory");
    const int c = lane & 7;
#pragma unroll
    for (int j = 0; j < 4; ++j) { const int nn = (lane >> 3) + 8 * j; const LAS float* s = scr + (8 * c) * 33 + nn;
        u32x4 o; o.x = pk2(s[0 * 33], s[1 * 33]); o.y = pk2(s[2 * 33], s[3 * 33]); o.z = pk2(s[4 * 33], s[5 * 33]); o.w = pk2(s[6 * 33], s[7 * 33]);
        *(u32x4*)(WT + (size_t)(dst_row0 + nn) * K + k0 + 8 * c) = o; }
    LDS_WAIT(); asm volatile("" ::: "memory");
}
__device__ __forceinline__ void rms_row_to_bf16(const float* xrow, bf16_t* orow, int lane) {
    const f32x4* xr = (const f32x4*)xrow + lane;
    f32x4 v[4]; float s = 0.f;
#pragma unroll
    for (int j = 0; j < 4; ++j) { v[j] = xr[64 * j]; s += (v[j].x * v[j].x + v[j].y * v[j].y) + (v[j].z * v[j].z + v[j].w * v[j].w); }
    const float rstd = rsqrtf(wave_sum(s) * (1.f / 1024.f) + EPS);
    u32x2* o8 = (u32x2*)orow + lane;
#pragma unroll
    for (int j = 0; j < 4; ++j) { u32x2 w; w.x = pk2(v[j].x * rstd, v[j].y * rstd); w.y = pk2(v[j].z * rstd, v[j].w * rstd); o8[64 * j] = w; }
}
struct In { const float *x, *mem, *g_in, *w_in, *w_uq, *g_cq, *w_ukv, *g_ckv, *g_qa, *g_ka, *g_qb, *g_kb, *g_mem, *w_mk, *w_mv, *g_qm, *g_km, *w_out; };

__device__ __forceinline__ void p0_prologue(const In& I, unsigned char* ws, LAS unsigned char* lds, int gw, int NGW, int wave, int lane) {
    LAS float* scr = (LAS float*)(lds + wave * 16384);
    constexpr int I_IN = 16 * 112, I_OUT = 16 * 32, I_UQ = 4 * 18, I_UKV = 2 * 24, I_M = 16 * 8 * 2;
    constexpr int NITEMS = I_IN + I_OUT + I_UQ + I_UKV + I_M;
    for (int it = gw; it < NITEMS; it += NGW) {
        int r = it;
        if (r < I_IN) { const int kb = r / 112, pg = r % 112, tile = pg >> 3, within = pg & 7, bj = within >> 2, wc = within & 3; int base, nv; slot_src(tile * 4 + wc, bj, base, nv);
            tr_item(I.w_in, 1024, NIN, 64 * kb, base, nv, I.g_in, (bf16_t*)(ws + WS_WIN), tile * 256 + bj * 128 + wc * 32, scr, lane); continue; }
        r -= I_IN;
        if (r < I_OUT) { const int kb = r / 32, nb = r % 32; tr_item(I.w_out, 1024, 1024, 64 * kb, 32 * nb, 32, nullptr, (bf16_t*)(ws + WS_WOUT), 32 * nb, scr, lane); continue; }
        r -= I_OUT;
        if (r < I_UQ) { const int kb = r / 18, nb = r % 18; tr_item(I.w_uq, 256, 576, 64 * kb, 32 * nb, 32, I.g_cq, (bf16_t*)(ws + WS_WUQ), 32 * nb, scr, lane); continue; }
        r -= I_UQ;
        if (r < I_UKV) { const int kb = r / 24, nb = r % 24; tr_item(I.w_ukv, 128, 768, 64 * kb, 32 * nb, 32, I.g_ckv, (bf16_t*)(ws + WS_WUKV), 32 * nb, scr, lane); continue; }
        r -= I_UKV;
        { const int which = r / 128, rr = r % 128, kb = rr / 8, nb = rr % 8; tr_item(which ? I.w_mv : I.w_mk, 1024, 256, 64 * kb, 32 * nb, 32, I.g_mem, (bf16_t*)(ws + WS_WM), which * 256 + 32 * nb, scr, lane); }
    }
    for (int m = gw; m < MTOK; m += NGW) rms_row_to_bf16(I.x + (size_t)m * DMODEL, (bf16_t*)(ws + WS_XN) + (size_t)m * DMODEL, lane);
    for (int m = gw; m < MMEM; m += NGW) rms_row_to_bf16(I.mem + (size_t)m * DMODEL, (bf16_t*)(ws + WS_MN) + (size_t)m * DMODEL, lane);
    { const int e = gw * 64 + lane; if (e < SEQ * 16) { const int pos = e >> 4, i = e & 15; const float inv = exp2f(-(float)i * (13.287712379549449f / 16.0f)); const float ang = (float)pos * inv;
        double tt = (double)ang * 0.15915494309189535; tt -= rint(tt); const float f = (float)tt;
        f32x2 cs; cs.x = __builtin_amdgcn_cosf(f); cs.y = __builtin_amdgcn_sinf(f); ((f32x2*)(ws + WS_ROPE))[e] = cs; } }
}

__device__ __forceinline__ float half_sum(float v) { auto rr = __builtin_amdgcn_permlane32_swap(__float_as_uint(v), __float_as_uint(v), false, false); return __uint_as_float(rr[0]) + __uint_as_float(rr[1]); }
__device__ __forceinline__ float half_max(float v) { auto rr = __builtin_amdgcn_permlane32_swap(__float_as_uint(v), __float_as_uint(v), false, false); return fmaxf(__uint_as_float(rr[0]), __uint_as_float(rr[1])); }
__device__ __forceinline__ void rope_tile(f32x16& a, const f32x2* rope, int pos, int hi) {
    const f32x4* rp = (const f32x4*)(rope + (size_t)pos * 16 + 4 * hi);
    const f32x4 c01 = rp[0], c23 = rp[1], c45 = rp[4], c67 = rp[5];
    const float cs[8] = {c01.x, c01.z, c23.x, c23.z, c45.x, c45.z, c67.x, c67.z}, sn[8] = {c01.y, c01.w, c23.y, c23.w, c45.y, c45.w, c67.y, c67.w};
#pragma unroll
    for (int r = 0; r < 8; ++r) { const float x1 = a[r], x2 = a[r + 8]; a[r] = x1 * cs[r] - x2 * sn[r]; a[r + 8] = x1 * sn[r] + x2 * cs[r]; }
}
__device__ __forceinline__ void store_tile_cols(bf16_t* dst  , const f32x16& a, int hi) {
#pragma unroll
    for (int g = 0; g < 4; ++g) { u32x2 w; w.x = cvt_pk_bf16(a[4 * g], a[4 * g + 1]); w.y = cvt_pk_bf16(a[4 * g + 2], a[4 * g + 3]); *(u32x2*)(dst + 8 * g + 4 * hi) = w; }
}
__device__ __forceinline__ void p2_q_task(int tg, int h, unsigned char* ws, const float* g_qb, int lane) {
    const int r32 = lane & 31, hi = lane >> 5, tok = tg * 32 + r32, pos = tok & (SEQ - 1), b = tok >> 12;
    const bf16_t* Cq = (const bf16_t*)(ws + WS_CQ) + (size_t)tok * 256 + 8 * hi;
    bf16x8 bq[16];
#pragma unroll
    for (int ks = 0; ks < 16; ++ks) bq[ks] = *(const bf16x8*)(Cq + 16 * ks);
    f32x16 acc[3];
#pragma unroll
    for (int c = 0; c < 3; ++c) { acc[c] = f32x16{}; const bf16_t* wrow = (const bf16_t*)(ws + WS_WUQ) + (size_t)(h * 96 + 32 * c + r32) * 256 + 8 * hi;
#pragma unroll
        for (int ks = 0; ks < 16; ++ks) { const bf16x8 a = *(const bf16x8*)(wrow + 16 * ks); acc[c] = MFMA32(a, bq[ks], acc[c]); } }
    const f32x4 s4 = *(const f32x4*)((const float*)(ws + WS_CQSS) + (size_t)tok * 4);
    const float rc = rsqrtf(((s4.x + s4.y) + (s4.z + s4.w)) * (1.0f / 256.0f) + EPS);
    float ss = 0.f;
#pragma unroll
    for (int c = 0; c < 3; ++c)
#pragma unroll
        for (int r = 0; r < 16; ++r) { acc[c][r] *= rc; ss += acc[c][r] * acc[c][r]; }
    ss = half_sum(ss);
    const float rs = rsqrtf(ss * (1.0f / 96.0f) + EPS) * C2_96;
#pragma unroll
    for (int c = 0; c < 3; ++c)
#pragma unroll
        for (int g = 0; g < 4; ++g) { const f32x4 gg = *(const f32x4*)(g_qb + 32 * c + 8 * g + 4 * hi);
#pragma unroll
            for (int i = 0; i < 4; ++i) acc[c][4 * g + i] *= rs * gg[i]; }
    rope_tile(acc[2], (const f32x2*)(ws + WS_ROPE), pos, hi);
    bf16_t* dst = (bf16_t*)(ws + WS_QB) + ((size_t)(b * 6 + h) * SEQ + pos) * 96;
#pragma unroll
    for (int c = 0; c < 3; ++c) store_tile_cols(dst + 32 * c, acc[c], hi);
}
__device__ __forceinline__ void p2_kv_task(int tg, int h, unsigned char* ws, const float* g_kb, int lane) {
    const int r32 = lane & 31, hi = lane >> 5, tok = tg * 32 + r32, pos = tok & (SEQ - 1), b = tok >> 12;
    const bf16_t* Ck = (const bf16_t*)(ws + WS_CKV) + (size_t)tok * 128 + 8 * hi;
    bf16x8 bk[8];
#pragma unroll
    for (int ks = 0; ks < 8; ++ks) bk[ks] = *(const bf16x8*)(Ck + 16 * ks);
    f32x16 acc[4];
#pragma unroll
    for (int c = 0; c < 4; ++c) { acc[c] = f32x16{}; const bf16_t* wrow = (const bf16_t*)(ws + WS_WUKV) + (size_t)(h * 128 + 32 * c + r32) * 128 + 8 * hi;
#pragma unroll
        for (int ks = 0; ks < 8; ++ks) { const bf16x8 a = *(const bf16x8*)(wrow + 16 * ks); acc[c] = MFMA32(a, bk[ks], acc[c]); } }
    const f32x2 s2 = *(const f32x2*)((const float*)(ws + WS_CKVSS) + (size_t)tok * 2);
    const float rc = rsqrtf((s2.x + s2.y) * (1.0f / 128.0f) + EPS);
#pragma unroll
    for (int c = 0; c < 4; ++c)
#pragma unroll
        for (int r = 0; r < 16; ++r) acc[c][r] *= rc;
    f32x16 kr;
    { const bf16_t* Kr = (const bf16_t*)(ws + WS_KR) + (size_t)tok * 32 + 4 * hi;
#pragma unroll
      for (int g = 0; g < 4; ++g) { const u32x2 w = *(const u32x2*)(Kr + 8 * g); kr[4 * g] = __uint_as_float(w.x << 16); kr[4 * g + 1] = __uint_as_float(w.x & 0xffff0000u); kr[4 * g + 2] = __uint_as_float(w.y << 16); kr[4 * g + 3] = __uint_as_float(w.y & 0xffff0000u); } }
    float ss = 0.f;
#pragma unroll
    for (int r = 0; r < 16; ++r) ss += acc[0][r] * acc[0][r] + acc[1][r] * acc[1][r] + kr[r] * kr[r];
    ss = half_sum(ss);
    const float rs = rsqrtf(ss * (1.0f / 96.0f) + EPS);
#pragma unroll
    for (int g = 0; g < 4; ++g) { const f32x4 g0 = *(const f32x4*)(g_kb + 8 * g + 4 * hi), g1 = *(const f32x4*)(g_kb + 32 + 8 * g + 4 * hi), g2 = *(const f32x4*)(g_kb + 64 + 8 * g + 4 * hi);
#pragma unroll
        for (int i = 0; i < 4; ++i) { acc[0][4 * g + i] *= rs * g0[i]; acc[1][4 * g + i] *= rs * g1[i]; kr[4 * g + i] *= rs * g2[i]; } }
    rope_tile(kr, (const f32x2*)(ws + WS_ROPE), pos, hi);
    bf16_t* kd = (bf16_t*)(ws + WS_KB) + ((size_t)(b * 6 + h) * SEQ + pos) * 96;
    store_tile_cols(kd, acc[0], hi); store_tile_cols(kd + 32, acc[1], hi); store_tile_cols(kd + 64, kr, hi);
    bf16_t* vd = (bf16_t*)(ws + WS_VB) + ((size_t)(b * 6 + h) * SEQ + pos) * 64;
    store_tile_cols(vd, acc[2], hi); store_tile_cols(vd + 32, acc[3], hi);
}

constexpr int SC_PITCH = 8200;
__device__ __forceinline__ unsigned f16key(unsigned h) { return (h & 0x8000u) ? (~h & 0xffffu) : (h | 0x8000u); }
__device__ __forceinline__ void idx_unit(int b, int g16, unsigned char* ws, LAS unsigned char* lds, int wave, int lane) {
    const int t0 = 16 * g16, c = t0 >> 6, N = 64 * (c + 1), ntile16 = N >> 4;
    const int fr = lane & 15, fq = lane >> 4;
    const bf16_t* Qi = (const bf16_t*)(ws + WS_QI) + ((size_t)(b * SEQ + t0 + fr) * 8) * 64 + 8 * fq;
    bf16x8 qf[8][2];
#pragma unroll
    for (int h = 0; h < 8; ++h) { qf[h][0] = *(const bf16x8*)(Qi + h * 64); qf[h][1] = *(const bf16x8*)(Qi + h * 64 + 32); }
    const float* Wi = (const float*)(ws + WS_WI) + (size_t)(b * SEQ + t0 + fr) * 8;
    const f32x4 w03 = *(const f32x4*)Wi, w47 = *(const f32x4*)(Wi + 4);
    const float wq[8] = {w03.x, w03.y, w03.z, w03.w, w47.x, w47.y, w47.z, w47.w};
    const bf16_t* Ki = (const bf16_t*)(ws + WS_KI) + (size_t)(b * SEQ + fr) * 64 + 8 * fq;
    for (int kt = wave; kt < ntile16; kt += 8) {
        const bf16x8 a0 = *(const bf16x8*)(Ki + (size_t)kt * 16 * 64), a1 = *(const bf16x8*)(Ki + (size_t)kt * 16 * 64 + 32);
        f32x4 sc = {0.f, 0.f, 0.f, 0.f};
#pragma unroll
        for (int h = 0; h < 8; ++h) { f32x4 acc = {0.f, 0.f, 0.f, 0.f}; acc = MFMA16(a0, qf[h][0], acc); acc = MFMA16(a1, qf[h][1], acc);
#pragma unroll
            for (int i = 0; i < 4; ++i) sc[i] = fmaf(wq[h], fmaxf(acc[i], 0.f), sc[i]); }
        typedef _Float16 h2 __attribute__((ext_vector_type(2)));
        const h2 lo = __builtin_convertvector((f32x2){sc[0], sc[1]}, h2), hh = __builtin_convertvector((f32x2){sc[2], sc[3]}, h2);
        u32x2 w; w.x = __builtin_bit_cast(unsigned, lo); w.y = __builtin_bit_cast(unsigned, hh);
        *(LAS u32x2*)(lds + fr * SC_PITCH + (kt * 16 + 4 * fq) * 2) = w;
    }
    __syncthreads();
    {
        const int q = 2 * wave + (lane >> 5), j = lane & 31, nt64 = c + 1;
        const LAS unsigned short* row = (const LAS unsigned short*)(lds + q * SC_PITCH);
        unsigned long long* mout = (unsigned long long*)(ws + WS_MASK) + (size_t)b * 64 * SEQ + t0 + q;
        if (N <= 256) {
            if (j == 0) for (int t = 0; t < nt64; ++t) mout[(size_t)t * SEQ] = ~0ull;
        } else {
            unsigned T = 0;
            for (int bit = 15; bit >= 0; --bit) {
                const unsigned cand = T | (1u << bit); int cnt = 0;
                for (int t = 0; t < nt64; ++t) { const unsigned k0 = f16key(row[t * 64 + j]), k1 = f16key(row[t * 64 + 32 + j]); cnt += (k0 >= cand) ? 1 : 0; cnt += (k1 >= cand) ? 1 : 0; }
                cnt += __shfl_xor(cnt, 1); cnt += __shfl_xor(cnt, 2); cnt += __shfl_xor(cnt, 4); cnt += __shfl_xor(cnt, 8); cnt += __shfl_xor(cnt, 16);
                if (cnt >= 256) T = cand;
            }
            int cgt = 0;
            for (int t = 0; t < nt64; ++t) { const unsigned k0 = f16key(row[t * 64 + j]), k1 = f16key(row[t * 64 + 32 + j]); cgt += (k0 > T) ? 1 : 0; cgt += (k1 > T) ? 1 : 0; }
            cgt += __shfl_xor(cgt, 1); cgt += __shfl_xor(cgt, 2); cgt += __shfl_xor(cgt, 4); cgt += __shfl_xor(cgt, 8); cgt += __shfl_xor(cgt, 16);
            int need = 256 - cgt;
            const unsigned below = (1u << j) - 1u; const int sh = (lane >> 5) * 32;
            for (int t = 0; t < nt64; ++t) {
                const unsigned k0 = f16key(row[t * 64 + j]), k1 = f16key(row[t * 64 + 32 + j]);
                bool s0 = k0 > T, s1 = k1 > T; const bool e0 = k0 == T, e1 = k1 == T;
                const unsigned be0 = (unsigned)(__ballot(e0) >> sh), be1 = (unsigned)(__ballot(e1) >> sh);
                const int n0 = __popc(be0), n1 = __popc(be1);
                s0 = s0 || (e0 && __popc(be0 & below) < need); s1 = s1 || (e1 && n0 + __popc(be1 & below) < need);
                need -= min(need, n0 + n1);
                const unsigned w0 = (unsigned)(__ballot(s0) >> sh), w1 = (unsigned)(__ballot(s1) >> sh);
                if (j == 0) mout[(size_t)t * SEQ] = (unsigned long long)w0 | ((unsigned long long)w1 << 32);
            }
        }
    }
    __syncthreads();
}

constexpr int AT_K0 = 0, AT_KSLOT = 12288, AT_V0 = 24576, AT_VSLOT = 8192, AT_WS = 40960, AT_OST = 43008, AT_BYTES = 75776;
typedef short v4i16_t __attribute__((ext_vector_type(4)));
__device__ __forceinline__ s16x4 vtr(const LAS char* p) { return __builtin_bit_cast(s16x4, __builtin_amdgcn_ds_read_tr16_b64_v4i16((LAS v4i16_t*)p)); }
template <int DQK, int MODE>
__device__ __forceinline__ void attn_unit(const bf16_t* Q, const bf16_t* K, const bf16_t* V, int NT, int q0, int qb4, const unsigned long long* maskp, float slope2,
                                          const bf16_t* Zp, bf16_t* Yp, LAS unsigned char* lds, int wave, int lane) {
    constexpr int NCH = DQK / 8, NKS = DQK / 16;
    const int r32 = lane & 31, hi = lane >> 5;
    const int ntw = (MODE == 0) ? NT : (qb4 + (wave >> 1) + 1);
    const bf16_t* ksrc0 = K + (size_t)lane * DQK + wave * 8;
    const bf16_t* vsrc = V + (size_t)(16 * (wave & 3) + (lane >> 2)) * 64 + (wave >> 2) * 32 + (lane & 3) * 8;
#define AT_ISSUE(t, sl) do { \
        __builtin_amdgcn_global_load_lds((const unsigned*)(ksrc0 + (size_t)(t) * 64 * DQK), (LAS unsigned*)(lds + AT_K0 + (sl) * AT_KSLOT + wave * 1024), 16, 0, 0); \
        if (NCH > 8 && wave + 8 < NCH) __builtin_amdgcn_global_load_lds((const unsigned*)(ksrc0 + (size_t)(t) * 64 * DQK + 64), (LAS unsigned*)(lds + AT_K0 + (sl) * AT_KSLOT + (wave + 8) * 1024), 16, 0, 0); \
        __builtin_amdgcn_global_load_lds((const unsigned*)(vsrc + (size_t)(t) * 64 * 64), (LAS unsigned*)(lds + AT_V0 + (sl) * AT_VSLOT + wave * 1024), 16, 0, 0); } while (0)
    AT_ISSUE(0, 0);
    const int qrow = q0 + wave * 32 + r32;
    bf16x8 qr[NKS];
#pragma unroll
    for (int d0 = 0; d0 < NKS; ++d0) qr[d0] = *(const bf16x8*)(Q + (size_t)qrow * DQK + d0 * 16 + hi * 8);
    LAS float* wsf = (LAS float*)(lds + AT_WS) + wave * 64;
    float m = -1e30f, l = 0.f; f32x16 o[2]; o[0] = f32x16{}; o[1] = f32x16{};
    unsigned long long mw = 0ull;
    if (MODE == 2) mw = maskp[qrow];
    for (int t = 0; t < NT; ++t) {
        __syncthreads();
        if (t + 1 < NT) AT_ISSUE(t + 1, (t + 1) & 1);
        if (t < ntw) {
            unsigned long long mw_next = 0ull;
            if (MODE == 2) { if (t + 1 < ntw) mw_next = maskp[(size_t)(t + 1) * SEQ + qrow]; }
            const LAS char* kb = (const LAS char*)(lds + AT_K0 + (t & 1) * AT_KSLOT + hi * 1024 + r32 * 16);
            f32x16 p0 = f32x16{}, p1 = f32x16{};
#pragma unroll
            for (int d0 = 0; d0 < NKS; ++d0) { const bf16x8 b0 = *(const LAS bf16x8*)(kb + d0 * 2048), b1 = *(const LAS bf16x8*)(kb + d0 * 2048 + 512);
                p0 = MFMA32(b0, qr[d0], p0); p1 = MFMA32(b1, qr[d0], p1); }
            if (MODE == 2) {
                const float dbase = (float)(qrow - 64 * t - 4 * hi);
                const unsigned mlo = (unsigned)(mw >> (4 * hi)), mhi = (unsigned)(mw >> (32 + 4 * hi));
#pragma unroll
                for (int r = 0; r < 16; ++r) { const int cr = (r & 3) + 8 * (r >> 2);
                    const float x0 = p0[r] - slope2 * fabsf(dbase - (float)cr), x1 = p1[r] - slope2 * fabsf(dbase - (float)(cr + 32));
                    p0[r] = ((mlo >> cr) & 1u) ? x0 : -INFINITY; p1[r] = ((mhi >> cr) & 1u) ? x1 : -INFINITY; }
            }
            float rm = fmaxf(p0[0], p1[0]);
#pragma unroll
            for (int r = 1; r < 16; ++r) rm = fmaxf(rm, fmaxf(p0[r], p1[r]));
            rm = half_max(rm);
            if (__any(rm > m + 8.0f)) {
                const float mn = fmaxf(m, rm), alpha = fast_exp2(m - mn); l *= alpha; m = mn;
                if (hi == 0) wsf[r32] = alpha;
                asm volatile("s_waitcnt lgkmcnt(0)" ::: "memory");
#pragma unroll
                for (int r = 0; r < 16; ++r) { const float a = wsf[crow(r, hi)]; o[0][r] *= a; o[1][r] *= a; }
                asm volatile("s_waitcnt lgkmcnt(0)" ::: "memory");
            }
            float ls = 0.f;
#pragma unroll
            for (int r = 0; r < 16; ++r) { p0[r] = fast_exp2(p0[r] - m); p1[r] = fast_exp2(p1[r] - m); ls += p0[r] + p1[r]; }
            l += ls;
            u32x4 pw[4];
#pragma unroll
            for (int k = 0; k < 4; ++k) { pw[0][k] = cvt_pk_bf16(p0[2 * k], p0[2 * k + 1]); pw[1][k] = cvt_pk_bf16(p0[8 + 2 * k], p0[9 + 2 * k]); pw[2][k] = cvt_pk_bf16(p1[2 * k], p1[2 * k + 1]); pw[3][k] = cvt_pk_bf16(p1[8 + 2 * k], p1[9 + 2 * k]); }
            const LAS char* vp = (const LAS char*)(lds + AT_V0 + (t & 1) * AT_VSLOT + ((lane >> 4) & 1) * 32 + (lane & 3) * 8 + (4 * hi + ((lane & 15) >> 2)) * 64);
#pragma unroll
            for (int d0 = 0; d0 < 2; ++d0)
#pragma unroll
                for (int ks = 0; ks < 4; ++ks) { const s16x4 lo = vtr(vp + d0 * 4096 + ks * 1024), hh = vtr(vp + d0 * 4096 + ks * 1024 + 512);
                    const bf16x8 vf = {lo[0], lo[1], lo[2], lo[3], hh[0], hh[1], hh[2], hh[3]};
                    o[d0] = MFMA32(__builtin_bit_cast(bf16x8, pw[ks]), vf, o[d0]); }
            mw = mw_next;
        }
    }
    l = half_sum(l);
    asm volatile("" ::: "memory");
    if (hi == 0) wsf[32 + r32] = l;
    asm volatile("s_waitcnt lgkmcnt(0)" ::: "memory");
    LAS bf16_t* stg = (LAS bf16_t*)(lds + AT_OST) + wave * 2048;
#pragma unroll
    for (int r = 0; r < 16; ++r) { const float rl = fast_rcp(wsf[32 + crow(r, hi)]); const int orow = crow(r, hi);
        stg[orow * 64 + r32] = (bf16_t)f2bf(o[0][r] * rl); stg[orow * 64 + 32 + r32] = (bf16_t)f2bf(o[1][r] * rl); }
    asm volatile("s_waitcnt lgkmcnt(0)" ::: "memory");
#pragma unroll
    for (int i = 0; i < 4; ++i) { const int row = i * 8 + (lane >> 3), ch = lane & 7;
        const u32x4 v = *(const LAS u32x4*)(stg + row * 64 + ch * 8); const size_t off = (size_t)(wave * 32 + row) * 1024 + ch * 8; const u32x4 g = *(const u32x4*)(Zp + off);
        u32x4 y;
#pragma unroll
        for (int k = 0; k < 4; ++k) y[k] = pk2(__uint_as_float(v[k] << 16) * __uint_as_float(g[k] << 16), __uint_as_float(v[k] & 0xffff0000u) * __uint_as_float(g[k] & 0xffff0000u));
        *(u32x4*)(Yp + off) = y; }
    __syncthreads();
#undef AT_ISSUE
}

struct Args { const float* in[18]; float* out; unsigned char* ws; int ph_lo, ph_hi, li, pad; };
constexpr int NPHASE = 5;
__global__ void __launch_bounds__(512, 2) mega_fwd(Args args) {
    extern __shared__ __attribute__((aligned(16))) unsigned char lds_raw[];
    LAS unsigned char* lds = (LAS unsigned char*)lds_raw;
    volatile LAS unsigned* MISC = (volatile LAS unsigned*)(lds + MISC_OFF);
    const int tid = threadIdx.x, lane = tid & 63, wave = __builtin_amdgcn_readfirstlane(tid >> 6);
    const int G = gridDim.x, bx = blockIdx.x;
    unsigned char* ws = args.ws; unsigned* ctl = (unsigned*)(ws + WS_CTL);
    In I; I.x = args.in[0]; I.mem = args.in[1]; I.g_in = args.in[2]; I.w_in = args.in[3]; I.w_uq = args.in[4]; I.g_cq = args.in[5]; I.w_ukv = args.in[6]; I.g_ckv = args.in[7]; I.g_qa = args.in[8]; I.g_ka = args.in[9];
    I.g_qb = args.in[10]; I.g_kb = args.in[11]; I.g_mem = args.in[12]; I.w_mk = args.in[13]; I.w_mv = args.in[14]; I.g_qm = args.in[15]; I.g_km = args.in[16]; I.w_out = args.in[17];
    for (int u = tid; u < 64; u += 512) MISC[u] = 0u;
    __syncthreads();
    XcdBarrier bar = xcd_barrier_post(ctl + CW_BAR + args.li * XCD_BAR_WORDS, MISC + 8);
    const int lo = args.ph_lo, hi_ = args.ph_hi;
#define IN(k) (lo <= (k) && (k) < hi_)
#define BOTH(k) (IN(k) && IN((k) + 1))
    if (IN(0)) { p0_prologue(I, ws, lds, bx * 8 + wave, G * 8, wave, lane); if (BOTH(0)) xcd_barrier(bar); }
    if (IN(1)) {
        { pg8::Gemm g{(const bf16_t*)(ws + WS_XN), (const bf16_t*)(ws + WS_WIN), MTOK, NINP, DMODEL}; pg8::StaticOrder S; S.init(MTOK, NINP, G, bx);
          pg8::EpiSlots<0> E{ws, I.g_qa, I.g_ka, I.g_qm, I.g_km};
          pg8::gemm_phase<pg8::EpiSlots<0>, pg8::StaticOrder, true, true>(lds, g, S, E); }
        { pg8::Gemm g{(const bf16_t*)(ws + WS_MN), (const bf16_t*)(ws + WS_WM), MMEM, 512, DMODEL}; pg8::StaticOrder S; S.init(MMEM, 512, G, bx);
          pg8::EpiSlots<1> E{ws, I.g_qa, I.g_ka, I.g_qm, I.g_km};
          pg8::gemm_phase<pg8::EpiSlots<1>, pg8::StaticOrder, true, true>(lds, g, S, E); }
        if (BOTH(1)) xcd_barrier(bar);
    }
    if (IN(2)) {
#if EN_A
        for (;;) { const int u = grab(ctl + CW_Q_IDX, (volatile LAS int*)(MISC + 16)); if (u >= NB * 256) break;
            const int cdesc = u >> 5, rem = u & 31, c = 63 - cdesc, b = rem & 7, g4 = rem >> 3;
            idx_unit(b, c * 4 + g4, ws, lds, wave, lane); }
#endif
#if EN_B
        for (;;) { const int u = grab(ctl + CW_Q_P2, (volatile LAS int*)(MISC + 16)); if (u >= 1536) break;
            const int task = u * 8 + wave, tg = task / 12, w = task % 12;
            if (w < 6) p2_q_task(tg, w, ws, I.g_qb, lane); else p2_kv_task(tg, w - 6, ws, I.g_kb, lane); }
#endif
        if (BOTH(2)) xcd_barrier(bar);
    }
    if (IN(3)) {
        for (;;) { const int u = grab(ctl + CW_Q_ATT, (volatile LAS int*)(MISC + 16)); if (u >= 2048) break;
            const bf16_t* Zb = (const bf16_t*)(ws + WS_Z); bf16_t* Yb = (bf16_t*)(ws + WS_Y);
            if (u < 1536) {
                const int qb = 15 - u / 96, rem = u % 96, isA = rem / 48, bh = rem % 48, b = bh / 6, h = bh % 6;
                const size_t rowoff = ((size_t)b * SEQ + qb * 256) * 1024;
                if (!isA) {
#if EN_B
                    attn_unit<96, 1>((const bf16_t*)(ws + WS_QB) + (size_t)bh * SEQ * 96, (const bf16_t*)(ws + WS_KB) + (size_t)bh * SEQ * 96, (const bf16_t*)(ws + WS_VB) + (size_t)bh * SEQ * 64,
                                     4 * qb + 4, qb * 256, 4 * qb, nullptr, 0.f, Zb + rowoff + 384 + h * 64, Yb + rowoff + 384 + h * 64, lds, wave, lane);
#else
                    for (int i = tid; i < 256 * 8; i += 512) *(u32x4*)(Yb + rowoff + (size_t)(i >> 3) * 1024 + 384 + h * 64 + (i & 7) * 8) = (u32x4){0u, 0u, 0u, 0u};
#endif
                } else {
#if EN_A
                    const float slope2 = exp2f(-8.0f * (float)(h + 1) / 6.0f) * LOG2E;
                    attn_unit<64, 2>((const bf16_t*)(ws + WS_QA) + (size_t)bh * SEQ * 64, (const bf16_t*)(ws + WS_KA) + (size_t)bh * SEQ * 64, (const bf16_t*)(ws + WS_VA) + (size_t)bh * SEQ * 64,
                                     4 * qb + 4, qb * 256, 4 * qb, (const unsigned long long*)(ws + WS_MASK) + (size_t)b * 64 * SEQ, slope2, Zb + rowoff + h * 64, Yb + rowoff + h * 64, lds, wave, lane);
#else
                    for (int i = tid; i < 256 * 8; i += 512) *(u32x4*)(Yb + rowoff + (size_t)(i >> 3) * 1024 + h * 64 + (i & 7) * 8) = (u32x4){0u, 0u, 0u, 0u};
#endif
                }
            } else {
                const int v = u - 1536, qb = v >> 5, bh = v & 31, b = bh >> 2, h = bh & 3;
                const size_t rowoff = ((size_t)b * SEQ + qb * 256) * 1024;
                attn_unit<64, 0>((const bf16_t*)(ws + WS_QM) + (size_t)bh * SEQ * 64, (const bf16_t*)(ws + WS_KM) + (size_t)bh * NMEM * 64, (const bf16_t*)(ws + WS_VM) + (size_t)bh * NMEM * 64,
                                 4, qb * 256, 0, nullptr, 0.f, Zb + rowoff + 768 + h * 64, Yb + rowoff + 768 + h * 64, lds, wave, lane);
            }
        }
        if (BOTH(3)) xcd_barrier(bar);
    }
    if (IN(4)) {
        pg8::Gemm g{(const bf16_t*)(ws + WS_Y), (const bf16_t*)(ws + WS_WOUT), MTOK, DMODEL, DMODEL}; pg8::StaticOrder S; S.init(MTOK, DMODEL, G, bx);
        pg8::EpiOut E{I.x, args.out};
        pg8::gemm_phase<pg8::EpiOut, pg8::StaticOrder, true, true>(lds, g, S, E);
    }
#undef IN
#undef BOTH
}

extern "C" void kernel_launch(void* const* d_in, const int* in_sizes, int n_in, void* d_out, int out_size, void* d_ws, size_t ws_size, hipStream_t stream) {
    static int grid = 0;
    if (grid == 0) {
        if (n_in != 18 || in_sizes[0] != MTOK * DMODEL || out_size != MTOK * DMODEL || ws_size < WS_END) {
            fprintf(stderr, "kernel_launch: unexpected shapes (n_in %d, in0 %d, out %d, ws %zu); nothing launched\n", n_in, n_in > 0 ? in_sizes[0] : -1, out_size, ws_size); grid = -1; return; }
        int dev = 0, cus = 0, per_cu = 0;
        if (hipGetDevice(&dev) != hipSuccess || hipDeviceGetAttribute(&cus, hipDeviceAttributeMultiprocessorCount, dev) != hipSuccess) { grid = -1; return; }
        if (hipFuncSetAttribute((const void*)mega_fwd, hipFuncAttributeMaxDynamicSharedMemorySize, LDS_BYTES) != hipSuccess) { fprintf(stderr, "kernel_launch: hipFuncSetAttribute failed\n"); grid = -1; return; }
        if (hipOccupancyMaxActiveBlocksPerMultiprocessor(&per_cu, (const void*)mega_fwd, 512, LDS_BYTES) != hipSuccess || per_cu < 1) { fprintf(stderr, "kernel_launch: occupancy query says %d\n", per_cu); }
        (void)hipGetLastError();
        grid = cus;
    }
    if (grid < 0) return;
    (void)hipMemsetAsync((char*)d_ws + WS_CTL, 0, CTL_ZERO_BYTES, stream);
    Args a{};
    for (int i = 0; i < 18; ++i) a.in[i] = (const float*)d_in[i];
    a.out = (float*)d_out; a.ws = (unsigned char*)d_ws;
#if MK_N_LAUNCHES == 1
    a.ph_lo = 0; a.ph_hi = NPHASE; a.li = 0;
    hipLaunchKernelGGL(mega_fwd, dim3(grid), dim3(512), LDS_BYTES, stream, a);
#else
    for (int li = 0; li < NPHASE; ++li) { a.ph_lo = li; a.ph_hi = li + 1; a.li = li; hipLaunchKernelGGL(mega_fwd, dim3(grid), dim3(512), LDS_BYTES, stream, a); }
#endif
}
```
